# Optimizing an MI355X kernel written in HIP

```python
import functools
import jax, jax.numpy as jnp
from jax import lax
import numpy as np


D_MODEL = 1024
BATCH = 2
SEQ = 8192
DEPTH = 1
DEC_BATCH = 8
DEC_SEQ = 32
PAST_LEN = 1024

CHUNK = 64
MIX_WIDTH = D_MODEL
SB_WIDTH = MIX_WIDTH // 2
SB_HEADS = 8
SB_HEAD_DIM = SB_WIDTH // SB_HEADS
SB_BLOCK = 128
SB_SCALE = SB_HEAD_DIM ** -0.5
GLA_WIDTH = MIX_WIDTH - SB_WIDTH
GLA_HEADS = 4
GLA_KEY_WIDTH = GLA_WIDTH // 2
GLA_HEAD_K = GLA_KEY_WIDTH // GLA_HEADS
GLA_HEAD_V = GLA_WIDTH // GLA_HEADS
GLA_SCALE = GLA_HEAD_K ** -0.5
GATE_RANK = 16
GATE_TAU = 16.0
D_FF = ((8 * D_MODEL // 3 + 127) // 128) * 128
IN_WIDTH = 3 * SB_WIDTH + 2 * GLA_KEY_WIDTH + 2 * GLA_WIDTH + GATE_RANK
EPS = 1e-6

kernel_name = 'hymba_stickbreak_gla_macaron_stream_step'


def rmsnorm(x, g):
    xf = x.astype(jnp.float32)
    y = xf * lax.rsqrt(jnp.mean(xf * xf, axis=-1, keepdims=True) + EPS)
    return (y * g.astype(jnp.float32)).astype(x.dtype)


def swiglu(h, w_gate, w_up, w_down):
    return (jax.nn.silu(h @ w_gate) * (h @ w_up)) @ w_down


def sb_weights_apply(q, k, v, q_pos, k_pos):
    z = jnp.einsum('bqhd,bkhd->bhqk', q.astype(jnp.float32), k.astype(jnp.float32)) * SB_SCALE
    causal = k_pos[None, :] < q_pos[:, None]
    log_fail = jnp.where(causal, jax.nn.log_sigmoid(-z), 0.0)
    after = lax.cumsum(log_fail, axis=3, reverse=True) - log_fail
    w = jnp.where(causal, jnp.exp(jax.nn.log_sigmoid(z) + after), 0.0)
    return jnp.einsum('bhqk,bkhd->bqhd', w, v.astype(jnp.float32)).astype(v.dtype)


def sb_prompt(q, k, v):
    B, S, H, dh = q.shape
    k_pos = jnp.arange(S)

    def one_block(i):
        start = i * SB_BLOCK
        qb = lax.dynamic_slice_in_dim(q, start, SB_BLOCK, axis=1)
        return sb_weights_apply(qb, k, v, start + jnp.arange(SB_BLOCK), k_pos)

    out = lax.map(one_block, jnp.arange(S // SB_BLOCK))
    return jnp.moveaxis(out, 0, 1).reshape(B, S, H, dh)


def sb_sample(q, k_new, v_new, cache_k, cache_v):
    P = cache_k.shape[1]
    T = q.shape[1]
    k = jnp.concatenate([cache_k.astype(k_new.dtype), k_new], axis=1)
    v = jnp.concatenate([cache_v.astype(v_new.dtype), v_new], axis=1)
    return sb_weights_apply(q, k, v, P + jnp.arange(T), jnp.arange(P + T))


def gla_scan(q, k, v, log_a, s0, chunk):
    B, T, H, dk = q.shape
    dv = v.shape[-1]
    n = T // chunk

    def to_chunks(a):
        return a.astype(jnp.float32).reshape(B, n, chunk, H, a.shape[-1]).transpose(1, 0, 3, 2, 4)

    mask = jnp.tril(jnp.ones((chunk, chunk), dtype=bool))

    def step(s, inp):
        qc, kc, vc, gc = inp
        b = jnp.cumsum(gc, axis=2)
        o_inter = jnp.einsum('bhtd,bhde->bhte', qc * jnp.exp(b), s)
        diff = b[:, :, :, None, :] - b[:, :, None, :, :]
        decay = jnp.exp(jnp.where(mask[:, :, None], diff, -jnp.inf))
        scores = jnp.einsum('bhtd,bhsd,bhtsd->bhts', qc, kc, decay)
        o_intra = jnp.einsum('bhts,bhse->bhte', scores, vc)
        b_last = b[:, :, -1:, :]
        s_new = jnp.exp(b_last[:, :, 0, :])[..., None] * s + jnp.einsum(
            'bhsd,bhse->bhde', kc * jnp.exp(b_last - b), vc)
        return s_new, o_inter + o_intra

    s_fin, o = lax.scan(step, s0.astype(jnp.float32),
                        (to_chunks(q), to_chunks(k), to_chunks(v), to_chunks(log_a)))
    o = o.transpose(1, 0, 3, 2, 4).reshape(B, T, H, dv)
    return o.astype(v.dtype), s_fin


def token_mixer(h, w_in, w_gate_up, b_gate, g_q, g_k, g_sb_out, g_gla_out, w_out, sb_fn, s0, gla_chunk):
    B, T, _ = h.shape
    proj = h @ w_in
    sizes = (SB_WIDTH, SB_WIDTH, SB_WIDTH, GLA_KEY_WIDTH, GLA_KEY_WIDTH, GLA_WIDTH, GLA_WIDTH)
    points, acc = [], 0
    for sz in sizes:
        acc += sz
        points.append(acc)
    q_sb, k_sb, v_sb, q_g, k_g, v_g, r_g, lr_g = jnp.split(proj, points, axis=-1)
    q_sb = rmsnorm(q_sb.reshape(B, T, SB_HEADS, SB_HEAD_DIM), g_q)
    k_sb = rmsnorm(k_sb.reshape(B, T, SB_HEADS, SB_HEAD_DIM), g_k)
    v_sb = v_sb.reshape(B, T, SB_HEADS, SB_HEAD_DIM)
    o_sb = rmsnorm(sb_fn(q_sb, k_sb, v_sb), g_sb_out).reshape(B, T, SB_WIDTH)
    q_g = q_g.reshape(B, T, GLA_HEADS, GLA_HEAD_K) * GLA_SCALE
    k_g = k_g.reshape(B, T, GLA_HEADS, GLA_HEAD_K)
    v_g = v_g.reshape(B, T, GLA_HEADS, GLA_HEAD_V)
    log_a = jax.nn.log_sigmoid((lr_g @ w_gate_up + b_gate).astype(jnp.float32)) / GATE_TAU
    log_a = log_a.reshape(B, T, GLA_HEADS, GLA_HEAD_K)
    o_g, s_fin = gla_scan(q_g, k_g, v_g, log_a, s0, gla_chunk)
    o_g = rmsnorm(o_g, g_gla_out).reshape(B, T, GLA_WIDTH) * jax.nn.silu(r_g)
    y = jnp.concatenate([o_sb, o_g], axis=-1) @ w_out
    return y, k_sb, v_sb, s_fin.astype(h.dtype)


def layer(x, lw, sb_fn, s0, gla_chunk):
    (g_ffn1, w1g, w1u, w1d, g_mix, w_in, w_gate_up, b_gate, g_q, g_k, g_sb_out, g_gla_out,
     w_out, g_ffn2, w2g, w2u, w2d, g_final) = lw
    x = x + 0.5 * swiglu(rmsnorm(x, g_ffn1), w1g, w1u, w1d)
    mix, k, v, s = token_mixer(rmsnorm(x, g_mix), w_in, w_gate_up, b_gate, g_q, g_k, g_sb_out,
                               g_gla_out, w_out, sb_fn, s0, gla_chunk)
    x = x + mix
    x = x + 0.5 * swiglu(rmsnorm(x, g_ffn2), w2g, w2u, w2d)
    return rmsnorm(x, g_final), k, v, s


def setup_inputs(seed: int = 0) -> dict:
    key = jax.random.key(seed)
    ks = jax.random.split(key, 32)

    def nrm(k, shape, scale):
        return jax.random.normal(k, shape, jnp.float32) * scale

    def gain(k, n):
        return 1.0 + nrm(k, (DEPTH, n), 0.05)

    return {
        'x_prompt': nrm(ks[0], (BATCH, SEQ, D_MODEL), 1.0),
        'x_sample': nrm(ks[1], (DEC_BATCH, DEC_SEQ, D_MODEL), 1.0),
        'cache_sb_k': nrm(ks[2], (DEPTH, DEC_BATCH, PAST_LEN, SB_HEADS, SB_HEAD_DIM), 1.0),
        'cache_sb_v': nrm(ks[3], (DEPTH, DEC_BATCH, PAST_LEN, SB_HEADS, SB_HEAD_DIM), 1.0),
        'state_gla': nrm(ks[4], (DEPTH, DEC_BATCH, GLA_HEADS, GLA_HEAD_K, GLA_HEAD_V), 0.5),
        'g_ffn1': gain(ks[5], D_MODEL),
        'w_ffn1_gate': nrm(ks[6], (DEPTH, D_MODEL, D_FF), D_MODEL ** -0.5),
        'w_ffn1_up': nrm(ks[7], (DEPTH, D_MODEL, D_FF), D_MODEL ** -0.5),
        'w_ffn1_down': nrm(ks[8], (DEPTH, D_FF, D_MODEL), D_FF ** -0.5),
        'g_mix': gain(ks[9], D_MODEL),
        'w_in': nrm(ks[10], (DEPTH, D_MODEL, IN_WIDTH), D_MODEL ** -0.5),
        'w_gate_up': nrm(ks[11], (DEPTH, GATE_RANK, GLA_KEY_WIDTH), GATE_RANK ** -0.5),
        'b_gate': nrm(ks[12], (DEPTH, GLA_KEY_WIDTH), 0.1),
        'g_q': gain(ks[13], SB_HEAD_DIM),
        'g_k': gain(ks[14], SB_HEAD_DIM),
        'g_sb_out': gain(ks[15], SB_HEAD_DIM),
        'g_gla_out': gain(ks[16], GLA_HEAD_V),
        'w_out': nrm(ks[17], (DEPTH, MIX_WIDTH, D_MODEL), MIX_WIDTH ** -0.5),
        'g_ffn2': gain(ks[18], D_MODEL),
        'w_ffn2_gate': nrm(ks[19], (DEPTH, D_MODEL, D_FF), D_MODEL ** -0.5),
        'w_ffn2_up': nrm(ks[20], (DEPTH, D_MODEL, D_FF), D_MODEL ** -0.5),
        'w_ffn2_down': nrm(ks[21], (DEPTH, D_FF, D_MODEL), D_FF ** -0.5),
        'g_final': gain(ks[22], D_MODEL),
    }


def reference(x_prompt, x_sample, cache_sb_k, cache_sb_v, state_gla, g_ffn1, w_ffn1_gate, w_ffn1_up,
              w_ffn1_down, g_mix, w_in, w_gate_up, b_gate, g_q, g_k, g_sb_out, g_gla_out, w_out,
              g_ffn2, w_ffn2_gate, w_ffn2_up, w_ffn2_down, g_final):
    y_p, y_s = x_prompt, x_sample
    pk, pv, ps, sk, sv, ss = [], [], [], [], [], []
    for l in range(DEPTH):
        lw = (g_ffn1[l], w_ffn1_gate[l], w_ffn1_up[l], w_ffn1_down[l], g_mix[l], w_in[l],
              w_gate_up[l], b_gate[l], g_q[l], g_k[l], g_sb_out[l], g_gla_out[l], w_out[l],
              g_ffn2[l], w_ffn2_gate[l], w_ffn2_up[l], w_ffn2_down[l], g_final[l])
        s0 = jnp.zeros((x_prompt.shape[0], GLA_HEADS, GLA_HEAD_K, GLA_HEAD_V), jnp.float32)
        y_p, k_p, v_p, s_p = layer(y_p, lw, sb_prompt, s0, CHUNK)
        sb_fn = functools.partial(sb_sample, cache_k=cache_sb_k[l], cache_v=cache_sb_v[l])
        y_s, k_s, v_s, s_s = layer(y_s, lw, sb_fn, state_gla[l], x_sample.shape[1])
        pk.append(k_p); pv.append(v_p); ps.append(s_p)
        sk.append(k_s); sv.append(v_s); ss.append(s_s)
    prompt_sb_k = jnp.stack(pk)
    prompt_sb_v = jnp.stack(pv)
    prompt_gla_state = jnp.stack(ps)
    sample_sb_k = jnp.stack(sk)
    sample_sb_v = jnp.stack(sv)
    sample_gla_state = jnp.stack(ss)
    return (y_p, y_s, prompt_sb_k, prompt_sb_v, prompt_gla_state, sample_sb_k, sample_sb_v, sample_gla_state)
```

```cpp
#include <hip/hip_runtime.h>
#include <hip/hip_cooperative_groups.h>
#include <cstdio>
#include <cstdint>
#include <cmath>
namespace cg = cooperative_groups;
constexpr int M = 16640, MP = 16384, DM = 1024, FF = 2816, NIN = 3328, NIN_SRC = 3088, NGU = 2 * FF;
constexpr int SEQ = 8192, NCH_P = 256  , GLA_UNITS = 1056  , KEYP_S = 1088;
constexpr size_t OUT_Y = 0, OUT_PK = 17039360, OUT_PV = 25427968, OUT_PS = 33816576, OUT_SK = 33882112, OUT_SV = 34013184, OUT_SS = 34144256, OUT_END = 34406400;
constexpr size_t WS_W1GU = 0, WS_W1D = 11534336, WS_WIN = 17301504, WS_WOUT = 24117248, WS_W2GU = 26214400, WS_W2D = 37748736;
constexpr size_t WS_XB = 43515904, WS_SS = 77594624, SS_BYTES = 1064960, WS_H = 81854464;
constexpr size_t WS_O = WS_H, WS_KP = WS_H + 34078720, WS_VTP = WS_H + 50855936, WS_GV = WS_H + 67633152, WS_GQ = WS_H + 84672512;
constexpr size_t WS_FREE = 175570944;
constexpr size_t WS_KS = WS_FREE, WS_VTS = WS_KS + 8912896, WS_GK = WS_VTS + 8912896, WS_LR = WS_GK + 8519680, WS_B = WS_LR + 1064960, WS_GU = WS_B + 17039360, WS_GD = WS_GU + 34603008, WS_END = WS_GD + 270336;
static_assert(WS_GQ + 8519680 <= WS_H + 93716480 && WS_END <= 268435456, "workspace map");
namespace pg8 {
#define PG8_LAS __attribute__((address_space(3)))
typedef unsigned short bf16_t;
typedef short bf16x8 __attribute__((ext_vector_type(8)));
typedef float f32x4 __attribute__((ext_vector_type(4)));
typedef unsigned u32x4 __attribute__((ext_vector_type(4)));
constexpr int BM = 256, BK = 64, HALF = 128, HTB = HALF * BK * 2  , STAGE_BYTES = 8 * HTB, NXCD = 8, WGM = 8;

__host__ __device__ __forceinline__ int lds_byte(int r, int c) { const int st = (r >> 4) * 2 + (c >> 5), rr = r & 15, cc = c & 31, ob = rr * 64 + cc * 2; return st * 1024 + (ob ^ (((ob >> 9) & 1) << 5)); }
__host__ __device__ __forceinline__ void stage_rc(int b, int& R, int& C) { const int st = b / 1024, sb = b % 1024, swz = sb ^ (((sb >> 9) & 1) << 5); R = (st >> 1) * 16 + swz / 64; C = (st & 1) * 32 + (swz % 64) / 2; }
__host__ __device__ __forceinline__ int perm32(int rho) { const int n = rho >> 4, i = rho & 15; return 8 * (i >> 2) + 4 * n + (i & 3); }

struct Unit { int pm, pn; };
struct Gemm { const bf16_t* A; const bf16_t* Bt; int M, N, K; };

struct StaticOrder {
    int nM, nN, nwg, G, c;
    __host__ __device__ void init(int M, int N, int G_, int c_) { nM = M / BM; nN = N / BM; nwg = nM * nN; G = G_; c = c_; }
    __host__ __device__ bool next(int i, Unit& u) const {
        const long L = (long)i * G + c; if (L >= nwg) return false;
        int wgid = (int)L; { const int q = nwg / NXCD, r = nwg % NXCD, xcd = wgid % NXCD, off = wgid / NXCD; wgid = (xcd < r ? xcd * (q + 1) : r * (q + 1) + (xcd - r) * q) + off; }
        const int nig = WGM * nN, gid = wgid / nig, fm = gid * WGM, gsz = (nM - fm) < WGM ? (nM - fm) : WGM;
        u.pm = fm + ((wgid % nig) % gsz); u.pn = (wgid % nig) / gsz; return true;
    }
    __device__ __forceinline__ void a_ready(const Unit&) const {}
    __device__ __forceinline__ void done(const Unit&) const {}
};

__device__ __forceinline__ unsigned cvt_pk_bf16(float lo, float hi) { unsigned r; asm volatile("v_cvt_pk_bf16_f32 %0, %1, %2" : "=v"(r) : "v"(lo), "v"(hi)); return r; }
typedef float f32x2 __attribute__((ext_vector_type(2)));
constexpr int ROWS_P = 16384;
__device__ __forceinline__ float row_rs(const float* ss, int row) {
    const f32x4* p = (const f32x4*)(ss + (size_t)row * 16); float s = 0.f;
#pragma unroll
    for (int i = 0; i < 4; ++i) { const f32x4 v = p[i]; s += (v[0] + v[1]) + (v[2] + v[3]); }
    return rsqrtf(s * (1.0f / 1024.0f) + 1e-6f);
}
__device__ __forceinline__ float silu_f(float g) { return g * __builtin_amdgcn_rcpf(1.0f + __expf(-g)); }
__device__ __forceinline__ u32x4 pack8(const float* v) { u32x4 w; w.x = cvt_pk_bf16(v[0], v[1]); w.y = cvt_pk_bf16(v[2], v[3]); w.z = cvt_pk_bf16(v[4], v[5]); w.w = cvt_pk_bf16(v[6], v[7]); return w; }

struct EpiSwiGLU {
    static constexpr bool PERM = true, AFTER_DRAIN = false;
    bf16_t* H; const float* ss;
    __device__ __forceinline__ void operator()(const f32x4 (&acc)[2][2][4][2], const Unit& u, int wr, int wc, int fr, int fq) const {
        const int row0 = u.pm * BM + wr * 64 + fr, col0 = u.pn * 128 + wc * 32 + 8 * fq;
#pragma unroll
        for (int ai = 0; ai < 2; ++ai)
#pragma unroll
            for (int m = 0; m < 4; ++m) { const int row = row0 + ai * HALF + m * 16; const float rs = row_rs(ss, row); float hv[8];
#pragma unroll
                for (int n = 0; n < 2; ++n)
#pragma unroll
                    for (int e = 0; e < 4; ++e) { const float g = acc[ai][0][m][n][e] * rs, up = acc[ai][1][m][n][e] * rs; hv[4 * n + e] = silu_f(g) * up; }
                *(u32x4*)(H + (size_t)row * 2816 + col0) = pack8(hv); }
    }
};

struct EpiRes {
    static constexpr bool PERM = false, AFTER_DRAIN = false;
    const float* baseP; long dS; float* Y; bf16_t* XB; float* ssout; float scale;
    __device__ __forceinline__ void operator()(const f32x4 (&acc)[2][2][4][2], const Unit& u, int wr, int wc, int fr, int fq) const {
        const int row0 = u.pm * BM + wr * 64 + fr, col0 = u.pn * BM + wc * 32 + 4 * fq;
#pragma unroll
        for (int ai = 0; ai < 2; ++ai)
#pragma unroll
            for (int m = 0; m < 4; ++m) { const int row = row0 + ai * HALF + m * 16;
                const float* bp = baseP + ((long)row * 1024 + (row < ROWS_P ? 0l : dS)); float sq = 0.f;
#pragma unroll
                for (int bj = 0; bj < 2; ++bj)
#pragma unroll
                    for (int n = 0; n < 2; ++n) { const int col = col0 + bj * HALF + n * 16; const f32x4 b = *(const f32x4*)(bp + col); const f32x4 v = b + acc[ai][bj][m][n] * scale;
                        *(f32x4*)(Y + (size_t)row * 1024 + col) = v; sq += (v[0] * v[0] + v[1] * v[1]) + (v[2] * v[2] + v[3] * v[3]);
                        if (XB) { typedef unsigned u32x2v __attribute__((ext_vector_type(2))); u32x2v w; w.x = cvt_pk_bf16(v[0], v[1]); w.y = cvt_pk_bf16(v[2], v[3]); *(u32x2v*)(XB + (size_t)row * 1024 + col) = w; } }
                sq += __shfl_xor(sq, 16); sq += __shfl_xor(sq, 32);
                if (fq == 0) ssout[(size_t)row * 16 + u.pn * 4 + wc] = sq; }
    }
};

struct EpiIn {
    static constexpr bool PERM = true, AFTER_DRAIN = false;
    const float* ss; const float* gq; const float* gk;
    unsigned char* ws; float* out;
    __device__ __forceinline__ void operator()(const f32x4 (&acc)[2][2][4][2], const Unit& u, int wr, int wc, int fr, int fq) const {
        const int pn = u.pn, row0 = u.pm * BM + wr * 64 + fr, cw = 64 * wc + 8 * fq;
        if (pn < 4) {
            const float* g = pn < 2 ? gq : gk; float gv[2][8];
#pragma unroll
            for (int bj = 0; bj < 2; ++bj)
#pragma unroll
                for (int j = 0; j < 8; ++j) gv[bj][j] = g[32 * bj + 8 * fq + j] * (pn < 2 ? 0.18033688011112042f : 1.0f);
            const int hcol = (pn & 1) * 256 + cw;
#pragma unroll
            for (int ai = 0; ai < 2; ++ai)
#pragma unroll
                for (int m = 0; m < 4; ++m) { const int row = row0 + ai * HALF + m * 16; const float rs = row_rs(ss, row); float v[2][8]; float s = 0.f;
#pragma unroll
                    for (int bj = 0; bj < 2; ++bj)
#pragma unroll
                        for (int n = 0; n < 2; ++n)
#pragma unroll
                            for (int e = 0; e < 4; ++e) { const float x = acc[ai][bj][m][n][e] * rs; v[bj][4 * n + e] = x; s += x * x; }
                    s += __shfl_xor(s, 16); s += __shfl_xor(s, 32);
                    const float hr = rsqrtf(s * (1.0f / 64.0f) + 1e-6f);
#pragma unroll
                    for (int bj = 0; bj < 2; ++bj)
#pragma unroll
                        for (int j = 0; j < 8; ++j) v[bj][j] *= hr * gv[bj][j];
                    if (pn < 2) {
#pragma unroll
                        for (int bj = 0; bj < 2; ++bj) *(u32x4*)((bf16_t*)(ws + WS_O) + (size_t)row * 1024 + hcol + 32 * bj) = pack8(v[bj]);
                    } else {
                        const bool smp = row >= ROWS_P; const int rl = row - ROWS_P;
                        float* ok = out + (smp ? OUT_SK + (size_t)rl * 512 : OUT_PK + (size_t)row * 512);
                        bf16_t* kb = (bf16_t*)(ws + (smp ? WS_KS + (((size_t)(rl >> 5) * 1088 + 1024 + (rl & 31)) * 512) * 2 : WS_KP + ((size_t)row * 512) * 2));
#pragma unroll
                        for (int bj = 0; bj < 2; ++bj) { *(f32x4*)(ok + hcol + 32 * bj) = (f32x4){v[bj][0], v[bj][1], v[bj][2], v[bj][3]}; *(f32x4*)(ok + hcol + 32 * bj + 4) = (f32x4){v[bj][4], v[bj][5], v[bj][6], v[bj][7]};
                            *(u32x4*)(kb + hcol + 32 * bj) = pack8(v[bj]); }
                    } }
        } else if (pn < 6) {
            const int hcol = (pn & 1) * 256 + cw;
#pragma unroll
            for (int ai = 0; ai < 2; ++ai)
#pragma unroll
                for (int m = 0; m < 4; ++m) { const int row = row0 + ai * HALF + m * 16; const float rs = row_rs(ss, row);
                    const bool smp = row >= ROWS_P; const int rl = row - ROWS_P;
                    float* ov = out + (smp ? OUT_SV + (size_t)rl * 512 : OUT_PV + (size_t)row * 512);
                    bf16_t* vt = (bf16_t*)(ws + (smp ? WS_VTS + ((size_t)(rl >> 5) * 512 * 1088 + 1024 + (rl & 31)) * 2 : WS_VTP + ((size_t)(row >> 13) * 512 * 8192 + (row & 8191)) * 2));
                    const size_t vp = smp ? 1088 : 8192;
#pragma unroll
                    for (int bj = 0; bj < 2; ++bj) { float v[8];
#pragma unroll
                        for (int n = 0; n < 2; ++n)
#pragma unroll
                            for (int e = 0; e < 4; ++e) v[4 * n + e] = acc[ai][bj][m][n][e] * rs;
                        *(f32x4*)(ov + hcol + 32 * bj) = (f32x4){v[0], v[1], v[2], v[3]}; *(f32x4*)(ov + hcol + 32 * bj + 4) = (f32x4){v[4], v[5], v[6], v[7]};
#pragma unroll
                        for (int j = 0; j < 8; j += 2) { const unsigned w = cvt_pk_bf16(v[j], v[j + 1]); vt[(size_t)(hcol + 32 * bj + j) * vp] = (bf16_t)(w & 0xffffu); vt[(size_t)(hcol + 32 * bj + j + 1) * vp] = (bf16_t)(w >> 16); } } }
        } else if (pn < 12) {
            size_t dofs; int ld, c0; float sc = 1.0f;
            if (pn == 6) { dofs = WS_GQ; ld = 256; c0 = cw; sc = 0.125f; } else if (pn == 7) { dofs = WS_GK; ld = 256; c0 = cw; }
            else if (pn < 10) { dofs = WS_GV; ld = 512; c0 = (pn - 8) * 256 + cw; } else { dofs = WS_O; ld = 1024; c0 = 512 + (pn - 10) * 256 + cw; }
            bf16_t* dst = (bf16_t*)(ws + dofs);
#pragma unroll
            for (int ai = 0; ai < 2; ++ai)
#pragma unroll
                for (int m = 0; m < 4; ++m) { const int row = row0 + ai * HALF + m * 16; const float rs = row_rs(ss, row) * sc;
#pragma unroll
                    for (int bj = 0; bj < 2; ++bj) { float v[8];
#pragma unroll
                        for (int n = 0; n < 2; ++n)
#pragma unroll
                            for (int e = 0; e < 4; ++e) { const float x = acc[ai][bj][m][n][e] * rs; v[4 * n + e] = pn >= 10 ? silu_f(x) : x; }
                        *(u32x4*)(dst + (size_t)row * ld + c0 + 32 * bj) = pack8(v); } }
        } else {
            if (wc == 0 && fq < 2) {
#pragma unroll
                for (int ai = 0; ai < 2; ++ai)
#pragma unroll
                    for (int m = 0; m < 4; ++m) { const int row = row0 + ai * HALF + m * 16; const float rs = row_rs(ss, row);
                        float* LR = (float*)(ws + WS_LR); *(f32x4*)(LR + (size_t)row * 16 + 8 * fq) = acc[ai][0][m][0] * rs; *(f32x4*)(LR + (size_t)row * 16 + 8 * fq + 4) = acc[ai][0][m][1] * rs; }
            }
        }
    }
};
template <class Epi, class Sched, bool ALIGN_EPI = false, bool SP2 = false>
__device__ __forceinline__ void gemm_phase(PG8_LAS unsigned char* lds, const Gemm g, const Sched& S, const Epi& E) {
    const int tid = threadIdx.x, wid = __builtin_amdgcn_readfirstlane(tid >> 6), lane = tid & 63, wr = wid >> 2, wc = wid & 3, fr = lane & 15, fq = lane >> 4;
    const int K = g.K, nt = K / BK;
    unsigned voffA[2], voffB[2];
#pragma unroll
    for (int i = 0; i < 2; ++i) { int R, C; stage_rc(tid * 16 + i * 8192, R, C); const int Rb = Epi::PERM ? ((R & ~31) + perm32(R & 31)) : R;
        voffA[i] = (unsigned)(R * K + C) * 2u; voffB[i] = (unsigned)(Rb * K + C) * 2u; }
    const size_t kstep = (size_t)(BK * 2);
    const size_t hstep = (size_t)HALF * K * 2;
    const size_t tstep = 2 * hstep;
    const unsigned ldsw = (unsigned)wid * 1024u;
    const int aoff = lds_byte(wr * 64 + fr, fq * 8), boff = lds_byte(wc * 32 + fr, fq * 8);
#define PG8_SA(b, h) (((b) * 2 + (h)) * HTB)
#define PG8_SB(b, h) ((4 + (b) * 2 + (h)) * HTB)
#define PG8_STAGE(bufoff, gbase, voff) do { _Pragma("unroll") for (int _i = 0; _i < 2; ++_i) \
        __builtin_amdgcn_global_load_lds((const unsigned*)((const char*)(gbase) + (voff)[_i]), (PG8_LAS unsigned*)(lds + (bufoff) + ldsw + _i * 8192), 16, 0, 0); } while (0)
#define PG8_LDA(dst, b, h) do { _Pragma("unroll") for (int m = 0; m < 4; ++m) _Pragma("unroll") for (int k = 0; k < 2; ++k) dst[m][k] = *(const PG8_LAS bf16x8*)(lds + PG8_SA(b, h) + aoff + m * 2048 + k * 1024); } while (0)
#define PG8_LDB(dst, b, h) do { _Pragma("unroll") for (int n = 0; n < 2; ++n) _Pragma("unroll") for (int k = 0; k < 2; ++k) dst[n][k] = *(const PG8_LAS bf16x8*)(lds + PG8_SB(b, h) + boff + n * 2048 + k * 1024); } while (0)
#define PG8_MMA(ai, bj, At, Bt) do { __builtin_amdgcn_s_setprio(1); _Pragma("unroll") for (int m = 0; m < 4; ++m) _Pragma("unroll") for (int n = 0; n < 2; ++n) _Pragma("unroll") for (int k = 0; k < 2; ++k) \
        acc[ai][bj][m][n] = __builtin_amdgcn_mfma_f32_16x16x32_bf16(Bt[n][k], At[m][k], acc[ai][bj][m][n], 0, 0, 0); __builtin_amdgcn_s_setprio(0); } while (0)
#define PG8_WAIT_V(n) asm volatile("s_waitcnt vmcnt(" #n ")" ::: "memory")
#define PG8_WAIT_L(n) asm volatile("s_waitcnt lgkmcnt(" #n ")" ::: "memory")
#define PG8_BAR __builtin_amdgcn_s_barrier()
#define PG8_SCHED __builtin_amdgcn_sched_barrier(0)
    Unit cur, nxt; int ui = 0;
    if (!S.next(0, cur)) return;
    f32x4 acc[2][2][4][2];
#pragma unroll
    for (int a = 0; a < 2; ++a)
#pragma unroll
        for (int b = 0; b < 2; ++b)
#pragma unroll
            for (int m = 0; m < 4; ++m)
#pragma unroll
                for (int n = 0; n < 2; ++n) acc[a][b][m][n] = (f32x4){0.f, 0.f, 0.f, 0.f};
    bf16x8 At[4][2], B0[2][2], B1[2][2];
    const char* cA = (const char*)g.A + (size_t)cur.pm * tstep; const char* cB = (const char*)g.Bt + (size_t)cur.pn * tstep;
    S.a_ready(cur);
    if constexpr (SP2) {
        PG8_STAGE(PG8_SB(0, 0), cB, voffB); PG8_STAGE(PG8_SB(0, 1), cB + hstep, voffB); PG8_STAGE(PG8_SA(0, 0), cA, voffA); PG8_STAGE(PG8_SA(0, 1), cA + hstep, voffA);
        if (wr == 1) PG8_BAR;
        PG8_WAIT_V(2); PG8_BAR;
        PG8_STAGE(PG8_SB(1, 0), cB + kstep, voffB); PG8_STAGE(PG8_SA(1, 0), cA + kstep, voffA); PG8_STAGE(PG8_SB(1, 1), cB + hstep + kstep, voffB);
        PG8_WAIT_V(6); PG8_BAR;
    } else {
        PG8_STAGE(PG8_SB(0, 0), cB, voffB); PG8_STAGE(PG8_SA(0, 0), cA, voffA); PG8_STAGE(PG8_SB(0, 1), cB + hstep, voffB); PG8_STAGE(PG8_SA(0, 1), cA + hstep, voffA);
        if (wr == 1) PG8_BAR;
        PG8_WAIT_V(4); PG8_BAR;
        PG8_STAGE(PG8_SB(1, 0), cB + kstep, voffB); PG8_STAGE(PG8_SA(1, 0), cA + kstep, voffA); PG8_STAGE(PG8_SB(1, 1), cB + hstep + kstep, voffB);
        PG8_WAIT_V(6); PG8_BAR;
    }
    for (;;) {
        const bool has_next = S.next(ui + 1, nxt);
        const char* nA = has_next ? (const char*)g.A + (size_t)nxt.pm * tstep : cA; const char* nB = has_next ? (const char*)g.Bt + (size_t)nxt.pn * tstep : cB;
        for (int t = 0; t < nt; t += 2) {
            const bool last = (t == nt - 2);
            const char* a1 = cA + (size_t)(t + 1) * kstep;
            const char* a2 = last ? nA : cA + (size_t)(t + 2) * kstep; const char* b2 = last ? nB : cB + (size_t)(t + 2) * kstep;
            const char* a3 = a2 + kstep; const char* b3 = b2 + kstep;
            if (last && has_next) S.a_ready(nxt);
            if constexpr (SP2) {
            PG8_LDB(B0, 0, 0); PG8_LDB(B1, 0, 1); PG8_SCHED; PG8_LDA(At, 0, 0); PG8_STAGE(PG8_SA(1, 1), a1 + hstep, voffA);
            PG8_WAIT_V(8); PG8_WAIT_L(0); PG8_BAR; PG8_MMA(0, 0, At, B0); PG8_MMA(0, 1, At, B1); PG8_BAR; PG8_SCHED;
            PG8_LDA(At, 0, 1); PG8_STAGE(PG8_SB(0, 0), b2, voffB); PG8_STAGE(PG8_SB(0, 1), b2 + hstep, voffB); PG8_STAGE(PG8_SA(0, 0), a2, voffA);
            PG8_WAIT_V(8); PG8_WAIT_L(0); PG8_BAR; PG8_MMA(1, 0, At, B0); PG8_MMA(1, 1, At, B1); PG8_BAR; PG8_SCHED;
            PG8_LDB(B0, 1, 0); PG8_LDB(B1, 1, 1); PG8_SCHED; PG8_LDA(At, 1, 0); PG8_STAGE(PG8_SA(0, 1), a2 + hstep, voffA);
            PG8_WAIT_V(8); PG8_WAIT_L(0); PG8_BAR; PG8_MMA(0, 0, At, B0); PG8_MMA(0, 1, At, B1); PG8_BAR; PG8_SCHED;
            PG8_LDA(At, 1, 1); PG8_STAGE(PG8_SB(1, 0), b3, voffB); PG8_STAGE(PG8_SB(1, 1), b3 + hstep, voffB); PG8_STAGE(PG8_SA(1, 0), a3, voffA);
            PG8_WAIT_V(8); PG8_WAIT_L(0); PG8_BAR; PG8_MMA(1, 0, At, B0); PG8_MMA(1, 1, At, B1); PG8_BAR; PG8_SCHED;
            } else {
            PG8_LDB(B0, 0, 0); PG8_SCHED; PG8_LDA(At, 0, 0); PG8_STAGE(PG8_SA(1, 1), a1 + hstep, voffA);
            PG8_WAIT_L(8); PG8_BAR; PG8_WAIT_L(0); PG8_MMA(0, 0, At, B0); PG8_BAR; PG8_SCHED;
            PG8_LDB(B1, 0, 1); PG8_STAGE(PG8_SB(0, 0), b2, voffB);
            PG8_BAR; PG8_WAIT_L(0); PG8_MMA(0, 1, At, B1); PG8_BAR;
            PG8_LDA(At, 0, 1); PG8_STAGE(PG8_SA(0, 0), a2, voffA);
            PG8_BAR; PG8_WAIT_L(0); PG8_MMA(1, 0, At, B0); PG8_BAR; PG8_SCHED;
            PG8_STAGE(PG8_SB(0, 1), b2 + hstep, voffB);
            PG8_WAIT_V(6); PG8_BAR; PG8_MMA(1, 1, At, B1); PG8_BAR;
            PG8_LDB(B0, 1, 0); PG8_SCHED; PG8_LDA(At, 1, 0); PG8_STAGE(PG8_SA(0, 1), a2 + hstep, voffA);
            PG8_WAIT_L(8); PG8_BAR; PG8_WAIT_L(0); PG8_MMA(0, 0, At, B0); PG8_BAR; PG8_SCHED;
            PG8_LDB(B1, 1, 1); PG8_STAGE(PG8_SB(1, 0), b3, voffB);
            PG8_BAR; PG8_WAIT_L(0); PG8_MMA(0, 1, At, B1); PG8_BAR;
            PG8_LDA(At, 1, 1); PG8_STAGE(PG8_SA(1, 0), a3, voffA);
            PG8_BAR; PG8_WAIT_L(0); PG8_MMA(1, 0, At, B0); PG8_BAR; PG8_SCHED;
            PG8_STAGE(PG8_SB(1, 1), b3 + hstep, voffB);
            PG8_WAIT_V(6); PG8_BAR; PG8_MMA(1, 1, At, B1); PG8_BAR;
            }
        }
        if constexpr (ALIGN_EPI) { if (wr == 0) PG8_BAR; }
        if constexpr (!Epi::AFTER_DRAIN) { E(acc, cur, wr, wc, fr, fq); S.done(cur); }
        if (!has_next) break;
#pragma unroll
        for (int a = 0; a < 2; ++a)
#pragma unroll
            for (int b = 0; b < 2; ++b)
#pragma unroll
                for (int m = 0; m < 4; ++m)
#pragma unroll
                    for (int n = 0; n < 2; ++n) acc[a][b][m][n] = (f32x4){0.f, 0.f, 0.f, 0.f};
        cur = nxt; cA = nA; cB = nB; ++ui;
        if constexpr (ALIGN_EPI) { if (wr == 1) PG8_BAR; }
    }
    PG8_WAIT_V(0);
    if constexpr (!ALIGN_EPI) { if (wr == 0) PG8_BAR; }
    PG8_BAR;
    if constexpr (Epi::AFTER_DRAIN) { E.fused(acc, cur, wr, wc, fr, fq, lds, wid, lane); S.done(cur); }
#undef PG8_SA
#undef PG8_SB
#undef PG8_STAGE
#undef PG8_LDA
#undef PG8_LDB
#undef PG8_MMA
#undef PG8_WAIT_V
#undef PG8_WAIT_L
#undef PG8_BAR
#undef PG8_SCHED
}
}

#define LAS __attribute__((address_space(3)))
typedef unsigned short bf16;
typedef short bf16x8 __attribute__((ext_vector_type(8)));
typedef short s16x4 __attribute__((ext_vector_type(4)));
typedef float f32x4 __attribute__((ext_vector_type(4)));
typedef float f32x16 __attribute__((ext_vector_type(16)));
typedef unsigned u32x4 __attribute__((ext_vector_type(4)));
typedef unsigned u32x2 __attribute__((ext_vector_type(2)));

constexpr int LDS_BYTES = 135168;

#define LDS_WAIT() asm volatile("s_waitcnt lgkmcnt(0)" ::: "memory")
__device__ __forceinline__ unsigned pk2(float lo, float hi) { unsigned r; asm("v_cvt_pk_bf16_f32 %0, %1, %2" : "=v"(r) : "v"(lo), "v"(hi)); return r; }
__device__ __forceinline__ float bf2f(unsigned short b) { return __uint_as_float((unsigned)b << 16); }
__device__ __forceinline__ float bflo(unsigned w) { return __uint_as_float(w << 16); }
__device__ __forceinline__ float bfhi(unsigned w) { return __uint_as_float(w & 0xffff0000u); }
__device__ __forceinline__ u32x4 pack8f(const float* v) { u32x4 w; w.x = pk2(v[0], v[1]); w.y = pk2(v[2], v[3]); w.z = pk2(v[4], v[5]); w.w = pk2(v[6], v[7]); return w; }
__device__ __forceinline__ float wave_sum(float v) {
#pragma unroll
    for (int o = 1; o < 64; o <<= 1) v += __shfl_xor(v, o);
    return v;
}

struct Args { const float* in[23]; float* out; unsigned char* ws; int ph_lo, ph_hi; };

__device__ __forceinline__ void tr_item(const float* __restrict__ W, int N, int src_n0, bf16* WT, int ldt, int dst_row0, const float* __restrict__ gain, int k0, LAS float* scr, int lane) {
#pragma unroll 8
    for (int i = 0; i < 32; ++i) { const int kk = 2 * i + (lane >> 5); const int n = src_n0 + (lane & 31);
        float v = (n < N) ? W[(size_t)(k0 + kk) * N + n] : 0.f; if (gain) v *= gain[k0 + kk]; scr[kk * 33 + (lane & 31)] = v; }
    LDS_WAIT();
    const int c = lane & 7;
#pragma unroll
    for (int j = 0; j < 4; ++j) { const int n = (lane >> 3) + 8 * j; const LAS float* s = scr + (8 * c) * 33 + n;
        u32x4 o; o.x = pk2(s[0 * 33], s[1 * 33]); o.y = pk2(s[2 * 33], s[3 * 33]); o.z = pk2(s[4 * 33], s[5 * 33]); o.w = pk2(s[6 * 33], s[7 * 33]);
        *(u32x4*)(WT + (size_t)(dst_row0 + n) * ldt + k0 + 8 * c) = o; }
    LDS_WAIT();
}

__device__ __forceinline__ void p0_prologue(const Args& a, LAS unsigned char* lds, int G) {
    const int tid = threadIdx.x, lane = tid & 63, wave = tid >> 6;
    unsigned char* ws = a.ws;
    LAS float* scr = (LAS float*)(lds + wave * 16384);
    const int gw = blockIdx.x * 8 + wave, NGW = G * 8;
    constexpr int I_GU = 16 * 88, I_DN = 44 * 32, I_IN = 16 * 104, I_OUT = 16 * 32, I_CV = 8 * 16 * 16;
    constexpr int NITEMS = 6 * I_GU + I_IN + I_OUT + I_CV;
    static_assert(I_GU == I_DN, "item counts");
    for (int it = gw; it < NITEMS; it += NGW) {
        int r = it;
        if (r < 6 * I_GU) {
            const int f = r / (3 * I_GU); r -= f * 3 * I_GU;
            const int which = r / I_GU; r -= which * I_GU;
            const float* gain = a.in[f ? 18 : 5];
            if (which < 2) { const int kb = r / 88, nb = r % 88;
                tr_item(a.in[(f ? 19 : 6) + which], FF, nb * 32, (bf16*)(ws + (f ? WS_W2GU : WS_W1GU)), 1024, (nb >> 2) * 256 + which * 128 + (nb & 3) * 32, gain, kb * 64, scr, lane);
            } else { const int kb = r / 32, nb = r % 32;
                tr_item(a.in[f ? 21 : 8], 1024, nb * 32, (bf16*)(ws + (f ? WS_W2D : WS_W1D)), FF, nb * 32, nullptr, kb * 64, scr, lane); }
            continue;
        }
        r -= 6 * I_GU;
        if (r < I_IN) { const int kb = r / 104, nb = r % 104, gd = nb & 7, gs = 2 * (gd & 3) + (gd >> 2);
            tr_item(a.in[10], NIN_SRC, (nb >> 3) * 256 + gs * 32, (bf16*)(ws + WS_WIN), 1024, nb * 32, a.in[9], kb * 64, scr, lane); continue; }
        r -= I_IN;
        if (r < I_OUT) { const int kb = r / 32, nb = r % 32; tr_item(a.in[17], 1024, nb * 32, (bf16*)(ws + WS_WOUT), 1024, nb * 32, nullptr, kb * 64, scr, lane); continue; }
        r -= I_OUT;
        { const int b = r >> 8, kb = (r >> 4) & 15, nb = r & 15;
          tr_item(a.in[3] + (size_t)b * 1024 * 512, 512, nb * 32, (bf16*)(ws + WS_VTS) + (size_t)b * 512 * KEYP_S, KEYP_S, nb * 32, nullptr, kb * 64, scr, lane); }
    }
    bf16* XB = (bf16*)(ws + WS_XB); float* SS0 = (float*)(ws + WS_SS);
    for (int m = gw; m < M; m += NGW) {
        const float* xr = (m < MP) ? a.in[0] + (size_t)m * DM : a.in[1] + (size_t)(m - MP) * DM;
        const f32x4* x4 = (const f32x4*)xr + lane; f32x4 v[4]; float s = 0.f;
#pragma unroll
        for (int j = 0; j < 4; ++j) { v[j] = x4[64 * j]; s += (v[j][0] * v[j][0] + v[j][1] * v[j][1]) + (v[j][2] * v[j][2] + v[j][3] * v[j][3]); }
        s = wave_sum(s);
        u32x2* o8 = (u32x2*)(XB + (size_t)m * DM) + lane;
#pragma unroll
        for (int j = 0; j < 4; ++j) { u32x2 w; w.x = pk2(v[j][0], v[j][1]); w.y = pk2(v[j][2], v[j][3]); o8[64 * j] = w; }
        if (lane < 16) SS0[(size_t)m * 16 + lane] = lane == 0 ? s : 0.f;
    }
    bf16* KS = (bf16*)(ws + WS_KS); bf16* VtS = (bf16*)(ws + WS_VTS);
    const int gt = blockIdx.x * 512 + tid, NT = G * 512;
    for (int i = gt; i < 8 * 1024 * 128; i += NT) { const int row = i >> 7, c4 = i & 127, b = row >> 10, key = row & 1023;
        const f32x4 v = ((const f32x4*)a.in[2])[i]; u32x2 w; w.x = pk2(v[0], v[1]); w.y = pk2(v[2], v[3]);
        *(u32x2*)(KS + ((size_t)b * KEYP_S + key) * 512 + c4 * 4) = w; }
    for (int i = gt; i < 8 * 32 * 512; i += NT) { const int b = i >> 14, rr = (i >> 9) & 31, c = i & 511;
        KS[((size_t)b * KEYP_S + 1056 + rr) * 512 + c] = 0; VtS[((size_t)b * 512 + c) * KEYP_S + 1056 + rr] = 0; }
}

__device__ __forceinline__ void final_norm(const Args& a, int G) {
    const int tid = threadIdx.x, lane = tid & 63, wave = tid >> 6; const int gw = blockIdx.x * 8 + wave, NGW = G * 8;
    const float* SS3 = (const float*)(a.ws + WS_SS + 3 * SS_BYTES); const f32x4* g4 = (const f32x4*)a.in[22] + lane;
    f32x4 gv[4];
#pragma unroll
    for (int j = 0; j < 4; ++j) gv[j] = g4[64 * j];
    for (int m = gw; m < M; m += NGW) { const float rs = pg8::row_rs(SS3, m); f32x4* y4 = (f32x4*)(a.out + (size_t)m * DM) + lane;
#pragma unroll
        for (int j = 0; j < 4; ++j) y4[64 * j] = y4[64 * j] * rs * gv[j]; }
}

__device__ __forceinline__ void gla_unit_rows(int unit, int& row0, int& h, int& valid) {
    if (unit < 1024) { row0 = (unit >> 2) * 64; h = unit & 3; valid = 64; } else { const int s = unit - 1024; row0 = MP + (s >> 2) * 32; h = s & 3; valid = 32; }
}
__device__ __forceinline__ bf16x8 lds_ld8(const LAS unsigned char* p) { return *(const LAS bf16x8*)p; }

__device__ __forceinline__ void gla_pass_a(const Args& a, LAS unsigned char* lds, int unit) {
    const int tid = threadIdx.x, lane = tid & 63, wave = tid >> 6;
    unsigned char* ws = a.ws;
    const float* LR = (const float*)(ws + WS_LR); const bf16* GK = (const bf16*)(ws + WS_GK); const bf16* GV = (const bf16*)(ws + WS_GV);
    float* Bb = (float*)(ws + WS_B); float* GU = (float*)(ws + WS_GU); float* GD = (float*)(ws + WS_GD);
    int row0, h, valid; gla_unit_rows(unit, row0, h, valid);
    LAS float* tot = (LAS float*)lds;
    LAS unsigned char* Kt = lds + 2048;
    LAS unsigned char* Vt = lds + 2048 + 9216;
    const int ch = tid & 63, tq = tid >> 6;
    float wg[16];
#pragma unroll
    for (int j = 0; j < 16; ++j) wg[j] = a.in[11][j * 256 + h * 64 + ch];
    const float bg = a.in[12][h * 64 + ch];
    float cs[8]; float run = 0.f;
#pragma unroll
    for (int i = 0; i < 8; ++i) { const int t = 8 * tq + i; float la = 0.f;
        if (t < valid) { const f32x4* lr = (const f32x4*)(LR + (size_t)(row0 + t) * 16); float x = bg;
#pragma unroll
            for (int q = 0; q < 4; ++q) { const f32x4 l4 = lr[q]; x += l4[0] * wg[4 * q] + l4[1] * wg[4 * q + 1] + l4[2] * wg[4 * q + 2] + l4[3] * wg[4 * q + 3]; }
            la = (fminf(x, 0.f) - __logf(1.0f + __expf(-fabsf(x)))) * (1.0f / 16.0f); }
        run += la; cs[i] = run; }
    tot[tq * 64 + ch] = run;
    __syncthreads();
    float off = 0.f, blast = 0.f;
#pragma unroll
    for (int q = 0; q < 8; ++q) { const float tv = tot[q * 64 + ch]; blast += tv; if (q < tq) off += tv; }
    float kh[8];
#pragma unroll
    for (int i = 0; i < 8; ++i) { const int t = 8 * tq + i; const float b = off + cs[i]; float kv = 0.f;
        if (t < valid) { Bb[(size_t)(row0 + t) * 256 + h * 64 + ch] = b; kv = bf2f(GK[(size_t)(row0 + t) * 256 + h * 64 + ch]); }
        kh[i] = kv * __expf(blast - b); }
    *(LAS u32x4*)(Kt + ch * 144 + tq * 16) = pack8f(kh);
    if (tq == 0) GD[(size_t)unit * 64 + ch] = __expf(blast);
    { const int dv = tid & 127, q4 = tid >> 7; unsigned w[8];
#pragma unroll
      for (int i = 0; i < 16; i += 2) { const int t = 16 * q4 + i;
          const unsigned lo = (t < valid) ? GV[(size_t)(row0 + t) * 512 + h * 128 + dv] : 0u, hi = (t + 1 < valid) ? GV[(size_t)(row0 + t + 1) * 512 + h * 128 + dv] : 0u;
          w[i >> 1] = lo | (hi << 16); }
      *(LAS u32x4*)(Vt + dv * 144 + q4 * 32) = (u32x4){w[0], w[1], w[2], w[3]}; *(LAS u32x4*)(Vt + dv * 144 + q4 * 32 + 16) = (u32x4){w[4], w[5], w[6], w[7]}; }
    __syncthreads();
    { const int i = lane & 15, g = lane >> 4; f32x4 acc[4];
#pragma unroll
      for (int mt = 0; mt < 4; ++mt) acc[mt] = (f32x4){0.f, 0.f, 0.f, 0.f};
#pragma unroll
      for (int ks = 0; ks < 2; ++ks) { const bf16x8 Bf = lds_ld8(Vt + (16 * wave + i) * 144 + (32 * ks + 8 * g) * 2);
#pragma unroll
          for (int mt = 0; mt < 4; ++mt) { const bf16x8 Af = lds_ld8(Kt + (16 * mt + i) * 144 + (32 * ks + 8 * g) * 2); acc[mt] = __builtin_amdgcn_mfma_f32_16x16x32_bf16(Af, Bf, acc[mt], 0, 0, 0); } }
      float* gu = GU + (size_t)unit * 8192 + (size_t)(16 * wave + i) * 64 + 4 * g;
#pragma unroll
      for (int mt = 0; mt < 4; ++mt) *(f32x4*)(gu + 16 * mt) = acc[mt]; }
    __syncthreads();
}

__device__ __forceinline__ void gla_scan(const Args& a, int G) {
    float* GU = (float*)(a.ws + WS_GU); const float* GD = (const float*)(a.ws + WS_GD);
    const int gt = blockIdx.x * 512 + threadIdx.x, NT = G * 512;
    for (int e = gt; e < 65536; e += NT) { const int bh = e >> 13, idx = e & 8191, dv = idx >> 6, dk = idx & 63, b = bh >> 2, h = bh & 3;
        float S = 0.f;
#pragma unroll 8
        for (int c = 0; c < 128; ++c) { const size_t unit = (size_t)(b * 128 + c) * 4 + h; const float u = GU[unit * 8192 + idx], d = GD[unit * 64 + dk]; GU[unit * 8192 + idx] = S; S = d * S + u; }
        a.out[OUT_PS + ((size_t)bh * 64 + dk) * 128 + dv] = S; }
    for (int e = gt; e < 262144; e += NT) { const int sh = e >> 13, idx = e & 8191, dv = idx >> 6, dk = idx & 63; const size_t unit = 1024 + sh;
        const float S0 = a.in[4][((size_t)sh * 64 + dk) * 128 + dv]; const float u = GU[unit * 8192 + idx], d = GD[unit * 64 + dk];
        GU[unit * 8192 + idx] = S0; a.out[OUT_SS + ((size_t)sh * 64 + dk) * 128 + dv] = d * S0 + u; }
}

__device__ __forceinline__ void gla_pass_c(const Args& a, LAS unsigned char* lds, int unit) {
    const int tid = threadIdx.x, lane = tid & 63, wave = tid >> 6;
    unsigned char* ws = a.ws;
    const bf16* GQ = (const bf16*)(ws + WS_GQ); const bf16* GK = (const bf16*)(ws + WS_GK); const bf16* GV = (const bf16*)(ws + WS_GV);
    const float* Bb = (const float*)(ws + WS_B); const float* GU = (const float*)(ws + WS_GU); bf16* O = (bf16*)(ws + WS_O);
    int row0, h, valid; gla_unit_rows(unit, row0, h, valid);
    LAS unsigned char* Qs = lds;
    LAS unsigned char* Ks = lds + 9216;
    LAS unsigned char* Vt = lds + 18432;
    LAS unsigned char* St = lds + 36864;
    LAS float* ssx = (LAS float*)(lds + 55296);
    { const int t = tid >> 3, c8 = tid & 7; float qv[8], kv[8];
      if (t < valid) { const size_t r = (size_t)(row0 + t);
          const f32x4 b0 = *(const f32x4*)(Bb + r * 256 + h * 64 + 8 * c8), b1 = *(const f32x4*)(Bb + r * 256 + h * 64 + 8 * c8 + 4);
          const u32x4 q8 = *(const u32x4*)(GQ + r * 256 + h * 64 + 8 * c8), k8 = *(const u32x4*)(GK + r * 256 + h * 64 + 8 * c8);
          const float bb[8] = {b0[0], b0[1], b0[2], b0[3], b1[0], b1[1], b1[2], b1[3]};
          const unsigned qw[4] = {q8.x, q8.y, q8.z, q8.w}, kw[4] = {k8.x, k8.y, k8.z, k8.w};
#pragma unroll
          for (int j = 0; j < 4; ++j) { const float e0 = __expf(bb[2 * j]), e1 = __expf(bb[2 * j + 1]);
              qv[2 * j] = bflo(qw[j]) * e0; qv[2 * j + 1] = bfhi(qw[j]) * e1; kv[2 * j] = bflo(kw[j]) * __builtin_amdgcn_rcpf(e0); kv[2 * j + 1] = bfhi(kw[j]) * __builtin_amdgcn_rcpf(e1); }
      } else {
#pragma unroll
          for (int j = 0; j < 8; ++j) { qv[j] = 0.f; kv[j] = 0.f; } }
      *(LAS u32x4*)(Qs + t * 144 + c8 * 16) = pack8f(qv); *(LAS u32x4*)(Ks + t * 144 + c8 * 16) = pack8f(kv); }
    { const int dv = tid & 127, q4 = tid >> 7; unsigned w[8];
#pragma unroll
      for (int i = 0; i < 16; i += 2) { const int t = 16 * q4 + i;
          const unsigned lo = (t < valid) ? GV[(size_t)(row0 + t) * 512 + h * 128 + dv] : 0u, hi = (t + 1 < valid) ? GV[(size_t)(row0 + t + 1) * 512 + h * 128 + dv] : 0u;
          w[i >> 1] = lo | (hi << 16); }
      *(LAS u32x4*)(Vt + dv * 144 + q4 * 32) = (u32x4){w[0], w[1], w[2], w[3]}; *(LAS u32x4*)(Vt + dv * 144 + q4 * 32 + 16) = (u32x4){w[4], w[5], w[6], w[7]}; }
    { const int dv = tid >> 2, c16 = tid & 3; const f32x4* s4 = (const f32x4*)(GU + (size_t)unit * 8192 + dv * 64 + 16 * c16); float sv[16];
#pragma unroll
      for (int q = 0; q < 4; ++q) { const f32x4 x = s4[q]; sv[4 * q] = x[0]; sv[4 * q + 1] = x[1]; sv[4 * q + 2] = x[2]; sv[4 * q + 3] = x[3]; }
      *(LAS u32x4*)(St + dv * 144 + c16 * 32) = pack8f(sv); *(LAS u32x4*)(St + dv * 144 + c16 * 32 + 16) = pack8f(sv + 8); }
    __syncthreads();
    const int i = lane & 15, g = lane >> 4, tt = wave & 3, dh = wave >> 2;
    bf16x8 Bq[2];
#pragma unroll
    for (int ks = 0; ks < 2; ++ks) Bq[ks] = lds_ld8(Qs + (16 * tt + i) * 144 + (32 * ks + 8 * g) * 2);
    f32x4 PT[4];
#pragma unroll
    for (int st = 0; st < 4; ++st) { PT[st] = (f32x4){0.f, 0.f, 0.f, 0.f};
        if (st <= tt) {
#pragma unroll
            for (int ks = 0; ks < 2; ++ks) PT[st] = __builtin_amdgcn_mfma_f32_16x16x32_bf16(lds_ld8(Ks + (16 * st + i) * 144 + (32 * ks + 8 * g) * 2), Bq[ks], PT[st], 0, 0, 0);
#pragma unroll
            for (int e = 0; e < 4; ++e) if (16 * st + 4 * g + e > 16 * tt + i) PT[st][e] = 0.f; } }
    bf16x8 Pf[2];
#pragma unroll
    for (int kk = 0; kk < 2; ++kk) { u32x4 w; w.x = pk2(PT[2 * kk][0], PT[2 * kk][1]); w.y = pk2(PT[2 * kk][2], PT[2 * kk][3]); w.z = pk2(PT[2 * kk + 1][0], PT[2 * kk + 1][1]); w.w = pk2(PT[2 * kk + 1][2], PT[2 * kk + 1][3]);
        Pf[kk] = __builtin_bit_cast(bf16x8, w); }
    f32x4 o[4]; float sq = 0.f;
#pragma unroll
    for (int nt = 0; nt < 4; ++nt) { const int dvb = 64 * dh + 16 * nt; o[nt] = (f32x4){0.f, 0.f, 0.f, 0.f};
#pragma unroll
        for (int kk = 0; kk < 2; ++kk) { const u32x2 lo = *(const LAS u32x2*)(Vt + (dvb + i) * 144 + (32 * kk + 4 * g) * 2), hi = *(const LAS u32x2*)(Vt + (dvb + i) * 144 + (32 * kk + 16 + 4 * g) * 2);
            const u32x4 w = {lo.x, lo.y, hi.x, hi.y}; o[nt] = __builtin_amdgcn_mfma_f32_16x16x32_bf16(__builtin_bit_cast(bf16x8, w), Pf[kk], o[nt], 0, 0, 0); }
#pragma unroll
        for (int ks = 0; ks < 2; ++ks) o[nt] = __builtin_amdgcn_mfma_f32_16x16x32_bf16(lds_ld8(St + (dvb + i) * 144 + (32 * ks + 8 * g) * 2), Bq[ks], o[nt], 0, 0, 0);
        sq += (o[nt][0] * o[nt][0] + o[nt][1] * o[nt][1]) + (o[nt][2] * o[nt][2] + o[nt][3] * o[nt][3]); }
    sq += __shfl_xor(sq, 16); sq += __shfl_xor(sq, 32);
    if (g == 0) ssx[dh * 64 + 16 * tt + i] = sq;
    __syncthreads();
    { const int t = 16 * tt + i; const float rs = rsqrtf((ssx[t] + ssx[64 + t]) * (1.0f / 128.0f) + 1e-6f);
      if (t < valid) { bf16* orow = O + (size_t)(row0 + t) * 1024 + 512 + h * 128;
#pragma unroll
          for (int nt = 0; nt < 4; ++nt) { const int dv = 64 * dh + 16 * nt + 4 * g; const u32x2 gr = *(const u32x2*)(orow + dv); const f32x4 gg = *(const f32x4*)(a.in[16] + dv);
              u32x2 w; w.x = pk2(o[nt][0] * rs * gg[0] * bflo(gr.x), o[nt][1] * rs * gg[1] * bfhi(gr.x)); w.y = pk2(o[nt][2] * rs * gg[2] * bflo(gr.y), o[nt][3] * rs * gg[3] * bfhi(gr.y));
              *(u32x2*)(orow + dv) = w; } } }
    __syncthreads();
}

__device__ __forceinline__ void sb_job(const Args& a, int job) {
    const int lane = threadIdx.x & 63, r = lane & 31, hh = lane >> 5;
    unsigned char* ws = a.ws; bf16* O = (bf16*)(ws + WS_O);
    bf16* Qp; const bf16* Kp; const bf16* Vp; size_t vp; int qpos0, kt0;
    if (job < 4096) { const int qblk = job & 255, bh = job >> 8, b = bh >> 3, h = bh & 7;
        Qp = O + ((size_t)b * SEQ + 32 * qblk) * 1024 + h * 64; Kp = (const bf16*)(ws + WS_KP) + (size_t)b * SEQ * 512 + h * 64; Vp = (const bf16*)(ws + WS_VTP) + ((size_t)b * 512 + h * 64) * SEQ; vp = SEQ; qpos0 = 32 * qblk; kt0 = qblk >> 1;
    } else { const int js = job - 4096, b = js >> 3, h = js & 7;
        Qp = O + ((size_t)MP + 32 * b) * 1024 + h * 64; Kp = (const bf16*)(ws + WS_KS) + (size_t)b * KEYP_S * 512 + h * 64; Vp = (const bf16*)(ws + WS_VTS) + ((size_t)b * 512 + h * 64) * KEYP_S; vp = KEYP_S; qpos0 = 1024; kt0 = 16; }
    bf16x8 Qf[4];
#pragma unroll
    for (int ks = 0; ks < 4; ++ks) Qf[ks] = *(const bf16x8*)(Qp + (size_t)r * 1024 + 16 * ks + 8 * hh);
    f32x16 o0, o1;
#pragma unroll
    for (int x = 0; x < 16; ++x) { o0[x] = 0.f; o1[x] = 0.f; }
    float C = 1.0f;
    const int krow = 32 * ((r >> 2) & 1) + 4 * (r >> 3) + (r & 3);
    const int qpos = qpos0 + r;
    for (int kt = kt0; kt >= 0; --kt) {
        f32x16 S0, S1;
#pragma unroll
        for (int x = 0; x < 16; ++x) { S0[x] = 0.f; S1[x] = 0.f; }
        const bf16* kp0 = Kp + (size_t)(64 * kt + krow) * 512 + 8 * hh;
#pragma unroll
        for (int ks = 0; ks < 4; ++ks) { const bf16x8 k0 = *(const bf16x8*)(kp0 + 16 * ks), k1 = *(const bf16x8*)(kp0 + 16 * 512 + 16 * ks);
            S0 = __builtin_amdgcn_mfma_f32_32x32x16_bf16(k0, Qf[ks], S0, 0, 0, 0); S1 = __builtin_amdgcn_mfma_f32_32x32x16_bf16(k1, Qf[ks], S1, 0, 0, 0); }
        const bf16* vp0 = Vp + (size_t)r * vp + 64 * kt + 32 * hh;
        bf16x8 Vf[2][4];
#pragma unroll
        for (int db = 0; db < 2; ++db)
#pragma unroll
            for (int q = 0; q < 4; ++q) Vf[db][q] = *(const bf16x8*)(vp0 + (size_t)(32 * db) * vp + 8 * q);
        const int kbase = 64 * kt + 32 * hh;
        if (kt == kt0) {
#pragma unroll
            for (int x = 0; x < 16; ++x) { if (kbase + x >= qpos) S0[x] = -INFINITY; if (kbase + 16 + x >= qpos) S1[x] = -INFINITY; }
        }
        float P = 1.0f; float wl[32];
#pragma unroll
        for (int x = 15; x >= 0; --x) { const float E = __builtin_amdgcn_exp2f(S1[x]); const float rr = __builtin_amdgcn_rcpf(1.0f + E); wl[16 + x] = (E * rr) * P; P *= rr; }
#pragma unroll
        for (int x = 15; x >= 0; --x) { const float E = __builtin_amdgcn_exp2f(S0[x]); const float rr = __builtin_amdgcn_rcpf(1.0f + E); wl[x] = (E * rr) * P; P *= rr; }
        const float Po = __shfl_xor(P, 32);
        const float F = hh ? C : C * Po;
        C = C * P * Po;
        bf16x8 Pf[4];
#pragma unroll
        for (int q = 0; q < 4; ++q) { u32x4 w; w.x = pk2(wl[8 * q] * F, wl[8 * q + 1] * F); w.y = pk2(wl[8 * q + 2] * F, wl[8 * q + 3] * F); w.z = pk2(wl[8 * q + 4] * F, wl[8 * q + 5] * F); w.w = pk2(wl[8 * q + 6] * F, wl[8 * q + 7] * F);
            Pf[q] = __builtin_bit_cast(bf16x8, w); }
#pragma unroll
        for (int q = 0; q < 4; ++q) { o0 = __builtin_amdgcn_mfma_f32_32x32x16_bf16(Vf[0][q], Pf[q], o0, 0, 0, 0); o1 = __builtin_amdgcn_mfma_f32_32x32x16_bf16(Vf[1][q], Pf[q], o1, 0, 0, 0); }
        if (__ballot(C >= 1e-30f) == 0ull) break;
    }
    float sq = 0.f;
#pragma unroll
    for (int x = 0; x < 16; ++x) sq += o0[x] * o0[x] + o1[x] * o1[x];
    sq += __shfl_xor(sq, 32);
    const float rs = rsqrtf(sq * (1.0f / 64.0f) + 1e-6f);
    bf16* orow = Qp + (size_t)r * 1024;
#pragma unroll
    for (int gq = 0; gq < 4; ++gq) { const int d0 = 8 * gq + 4 * hh; const f32x4 g0 = *(const f32x4*)(a.in[15] + d0), g1 = *(const f32x4*)(a.in[15] + 32 + d0);
        u32x2 w0, w1; w0.x = pk2(o0[4 * gq] * rs * g0[0], o0[4 * gq + 1] * rs * g0[1]); w0.y = pk2(o0[4 * gq + 2] * rs * g0[2], o0[4 * gq + 3] * rs * g0[3]);
        w1.x = pk2(o1[4 * gq] * rs * g1[0], o1[4 * gq + 1] * rs * g1[1]); w1.y = pk2(o1[4 * gq + 2] * rs * g1[2], o1[4 * gq + 3] * rs * g1[3]);
        *(u32x2*)(orow + d0) = w0; *(u32x2*)(orow + 32 + d0) = w1; }
}

__global__ void __launch_bounds__(512, 2) hymba_fwd(Args a) {
    extern __shared__ __attribute__((aligned(16))) unsigned char lds_raw[];
    LAS unsigned char* lds = (LAS unsigned char*)lds_raw;
    cg::grid_group grid = cg::this_grid();
    const int G = gridDim.x, lo = a.ph_lo, hi = a.ph_hi;
    unsigned char* ws = a.ws;
    bf16* XB = (bf16*)(ws + WS_XB); bf16* Hb = (bf16*)(ws + WS_H); bf16* Ob = (bf16*)(ws + WS_O);
    float* SS0 = (float*)(ws + WS_SS); float* SS1 = SS0 + SS_BYTES / 4; float* SS2 = SS1 + SS_BYTES / 4; float* SS3 = SS2 + SS_BYTES / 4;
    float* Y = a.out + OUT_Y;
#define IN(k) (lo <= (k) && (k) < hi)
#define SEAM(k) do { if ((k) + 1 < hi) grid.sync(); } while (0)
    if (IN(0)) { p0_prologue(a, lds, G); SEAM(0); }
    if (IN(1)) { pg8::Gemm g{XB, (const bf16*)(ws + WS_W1GU), M, NGU, DM}; pg8::StaticOrder S; S.init(M, NGU, G, (int)blockIdx.x); pg8::EpiSwiGLU E{Hb, SS0};
        pg8::gemm_phase<pg8::EpiSwiGLU, pg8::StaticOrder, true, true>(lds, g, S, E); SEAM(1); }
    if (IN(2)) { pg8::Gemm g{Hb, (const bf16*)(ws + WS_W1D), M, DM, FF}; pg8::StaticOrder S; S.init(M, DM, G, (int)blockIdx.x); pg8::EpiRes E{a.in[0], (long)(a.in[1] - a.in[0]) - (long)MP * DM, Y, XB, SS1, 0.5f};
        pg8::gemm_phase<pg8::EpiRes, pg8::StaticOrder, true, true>(lds, g, S, E); SEAM(2); }
    if (IN(3)) { pg8::Gemm g{XB, (const bf16*)(ws + WS_WIN), M, NIN, DM}; pg8::StaticOrder S; S.init(M, NIN, G, (int)blockIdx.x);
        pg8::EpiIn E{SS1, a.in[13], a.in[14], ws, a.out};
        pg8::gemm_phase<pg8::EpiIn, pg8::StaticOrder, true, true>(lds, g, S, E); SEAM(3); }
    if (IN(4)) {
        for (int u = blockIdx.x; u < GLA_UNITS; u += G) gla_pass_a(a, lds, u);
        const int wave = threadIdx.x >> 6;
        for (int j = wave * G + blockIdx.x; j < 4096 + 64; j += 8 * G) sb_job(a, j);
        SEAM(4); }
    if (IN(5)) { gla_scan(a, G); SEAM(5); }
    if (IN(6)) { for (int u = blockIdx.x; u < GLA_UNITS; u += G) gla_pass_c(a, lds, u); SEAM(6); }
    if (IN(7)) { pg8::Gemm g{Ob, (const bf16*)(ws + WS_WOUT), M, DM, DM}; pg8::StaticOrder S; S.init(M, DM, G, (int)blockIdx.x); pg8::EpiRes E{Y, 0l, Y, XB, SS2, 1.0f};
        pg8::gemm_phase<pg8::EpiRes, pg8::StaticOrder, true, true>(lds, g, S, E); SEAM(7); }
    if (IN(8)) { pg8::Gemm g{XB, (const bf16*)(ws + WS_W2GU), M, NGU, DM}; pg8::StaticOrder S; S.init(M, NGU, G, (int)blockIdx.x); pg8::EpiSwiGLU E{Hb, SS2};
        pg8::gemm_phase<pg8::EpiSwiGLU, pg8::StaticOrder, true, true>(lds, g, S, E); SEAM(8); }
    if (IN(9)) { pg8::Gemm g{Hb, (const bf16*)(ws + WS_W2D), M, DM, FF}; pg8::StaticOrder S; S.init(M, DM, G, (int)blockIdx.x); pg8::EpiRes E{Y, 0l, Y, nullptr, SS3, 0.5f};
        pg8::gemm_phase<pg8::EpiRes, pg8::StaticOrder, true, true>(lds, g, S, E); SEAM(9); }
    if (IN(10)) { final_norm(a, G); }
#undef IN
#undef SEAM
}

#ifndef MK_N_LAUNCHES
#define MK_N_LAUNCHES 1
#endif
extern "C" void kernel_launch(void* const* d_in, const int* in_sizes, int n_in, void* d_out, int out_size, void* d_ws, size_t ws_size, hipStream_t stream) {
    static int grid = 0;
    if (grid == 0) {
        if (n_in != 23 || out_size != (int)OUT_END || ws_size < WS_END) { fprintf(stderr, "kernel_launch: unexpected shapes (n_in %d, out %d, ws %zu); nothing launched\n", n_in, out_size, ws_size); grid = -1; return; }
        int dev = 0, cus = 0, per_cu = 0;
        if (hipGetDevice(&dev) != hipSuccess || hipDeviceGetAttribute(&cus, hipDeviceAttributeMultiprocessorCount, dev) != hipSuccess) { grid = -1; return; }
        if (hipFuncSetAttribute((const void*)hymba_fwd, hipFuncAttributeMaxDynamicSharedMemorySize, LDS_BYTES) != hipSuccess) { fprintf(stderr, "kernel_launch: hipFuncSetAttribute failed\n"); grid = -1; return; }
        if (hipOccupancyMaxActiveBlocksPerMultiprocessor(&per_cu, (const void*)hymba_fwd, 512, LDS_BYTES) != hipSuccess || per_cu < 1) { fprintf(stderr, "kernel_launch: occupancy query says %d\n", per_cu); per_cu = 1; }
        (void)hipGetLastError();
        grid = cus * per_cu;
    }
    if (grid < 0) return;
    Args a{};
    for (int i = 0; i < 23; ++i) a.in[i] = (const float*)d_in[i];
    a.out = (float*)d_out; a.ws = (unsigned char*)d_ws;
    if (MK_N_LAUNCHES == 1) {
        a.ph_lo = 0; a.ph_hi = 11;
        void* args[] = {&a};
        const hipError_t e = hipLaunchCooperativeKernel((const void*)hymba_fwd, dim3(grid), dim3(512), args, LDS_BYTES, stream);
        if (e != hipSuccess) fprintf(stderr, "kernel_launch: cooperative launch failed: %s (grid %d)\n", hipGetErrorString(e), grid);
    } else {
        for (int p = 0; p < 11; ++p) { a.ph_lo = p; a.ph_hi = p + 1; hipLaunchKernelGGL(hymba_fwd, dim3(grid), dim3(512), LDS_BYTES, stream, a); }
    }
}
```
